# Optimizing an MI355X kernel written in HIP

```python
import jax, jax.numpy as jnp
from jax import lax
import numpy as np

D_MODEL = 1024
BATCH = 8
SEQ = 2048
DEPTH = 2
DEC_BATCH = 128
DEC_SEQ = 4
PAST_LEN = 16384
PAGE_SIZE = 128

N_META = 16
GLA_HEADS = 4
GLA_DK = D_MODEL // 2
GLA_DV = D_MODEL
GLA_DKH = GLA_DK // GLA_HEADS
GLA_DVH = GLA_DV // GLA_HEADS
GATE_RANK = 16
GATE_TAU = 16.0
GLA_CHUNK = 64
POOL_WIDTH = D_MODEL // 2
POOL_WINDOWS = (2, 4, 8, 16)
POOL_GROUPS = len(POOL_WINDOWS)
POOL_GW = POOL_WIDTH // POOL_GROUPS
POOL_BUF = max(POOL_WINDOWS) - 1
N_BRANCH = 2
EPS = 1e-6
IN_SIZES = (GLA_DK, GLA_DK, GLA_DV, GLA_DV, POOL_WIDTH, POOL_WIDTH, GATE_RANK, N_BRANCH * D_MODEL)
IN_OFFSETS = tuple(int(o) for o in np.cumsum(IN_SIZES)[:-1])
IN_COLS = int(sum(IN_SIZES))

kernel_name = "gla_pool_hybrid_step"


def rmsnorm(x, g):
    xf = x.astype(jnp.float32)
    y = xf * lax.rsqrt(jnp.mean(xf * xf, axis=-1, keepdims=True) + EPS)
    return (y * g.astype(jnp.float32)).astype(x.dtype)


def gla_chunk_step(S, chunk):
    q, k, v, la = chunk
    qf = q.astype(jnp.float32)
    kf = k.astype(jnp.float32)
    vf = v.astype(jnp.float32)
    b = jnp.cumsum(la, axis=2)
    C = q.shape[2]
    causal = jnp.tril(jnp.ones((C, C), dtype=bool))
    diff = b[:, :, :, None, :] - b[:, :, None, :, :]
    decay = jnp.exp(jnp.where(causal[None, None, :, :, None], diff, -jnp.inf))
    A = jnp.einsum('bhid,bhjd,bhijd->bhij', qf, kf, decay)
    o = jnp.einsum('bhij,bhjv->bhiv', A, vf) + jnp.einsum('bhid,bhdv->bhiv', qf * jnp.exp(b), S)
    bC = b[:, :, -1:, :]
    kd = kf * jnp.exp(bC - b)
    S_new = jnp.exp(bC[:, :, 0, :])[..., None] * S + jnp.einsum('bhjd,bhjv->bhdv', kd, vf)
    return S_new, o


def gla_scan(q, k, v, la, S0, chunk):
    B, L, H, _ = q.shape
    DV = v.shape[-1]
    n = L // chunk

    def to_chunks(t):
        return t.reshape(B, n, chunk, H, t.shape[-1]).transpose(1, 0, 3, 2, 4)

    S, o = lax.scan(gla_chunk_step, S0.astype(jnp.float32),
                    (to_chunks(q), to_chunks(k), to_chunks(v), to_chunks(la)))
    o = o.transpose(1, 0, 3, 2, 4).reshape(B, L, H, DV)
    return o, S


def pool_mix(u_ext, n_prev, pos0, w_pool, scale):
    B, T, C = u_ext.shape
    L = T - n_prev
    uf = u_ext.astype(jnp.float32)
    cs = jnp.concatenate([jnp.zeros((B, 1, C), jnp.float32), jnp.cumsum(uf, axis=1)], axis=1)
    idx = n_prev + np.arange(L)
    pos = pos0 + np.arange(L)
    hi = cs[:, idx + 1]
    u_new = uf[:, n_prev:]
    outs = []
    for g, w in enumerate(POOL_WINDOWS):
        sl = slice(g * POOL_GW, (g + 1) * POOL_GW)
        lo = cs[:, np.maximum(idx + 1 - w, 0), sl]
        cnt = jnp.asarray(np.minimum(w, pos + 1), jnp.float32)[None, :, None]
        z = (hi[..., sl] - lo) / cnt - u_new[..., sl]
        outs.append(jnp.einsum('blc,cd->bld', z, w_pool[g].astype(jnp.float32)))
    return jnp.concatenate(outs, axis=-1) * scale.astype(jnp.float32)


def run_layer(h, prompt, S0, buf, norm_g, w_in, w_alpha, b_alpha, gla_gain, w_a,
              pool_w, pool_scale, w_b, b_merge, w_out):
    B, L, _ = h.shape
    dt = h.dtype
    xn = rmsnorm(h, norm_g)
    z = xn @ w_in
    q, k, v, ga, u, gb, alow, mg = jnp.split(z, IN_OFFSETS, axis=-1)
    q = q.reshape(B, L, GLA_HEADS, GLA_DKH) * (GLA_DKH ** -0.5)
    k = k.reshape(B, L, GLA_HEADS, GLA_DKH)
    v = v.reshape(B, L, GLA_HEADS, GLA_DVH)
    la = jax.nn.log_sigmoid(alow.astype(jnp.float32) @ w_alpha.astype(jnp.float32)
                            + b_alpha.astype(jnp.float32)) / GATE_TAU
    la = la.reshape(B, L, GLA_HEADS, GLA_DKH)
    if prompt:
        S_meta = jnp.zeros((B, GLA_HEADS, GLA_DKH, GLA_DVH), jnp.float32)
        o_m, S1 = gla_scan(q[:, :N_META], k[:, :N_META], v[:, :N_META], la[:, :N_META], S_meta, N_META)
        o_r, S_new = gla_scan(q[:, N_META:], k[:, N_META:], v[:, N_META:], la[:, N_META:], S1, GLA_CHUNK)
        o = jnp.concatenate([o_m, o_r], axis=1)
        y_pool = pool_mix(u, 0, 0, pool_w, pool_scale)
        buf_new = u[:, -POOL_BUF:]
    else:
        o, S_new = gla_scan(q, k, v, la, S0, L)
        u_ext = jnp.concatenate([buf.astype(u.dtype), u], axis=1)
        y_pool = pool_mix(u_ext, POOL_BUF, PAST_LEN, pool_w, pool_scale)
        buf_new = u_ext[:, -POOL_BUF:]
    o = o * lax.rsqrt(jnp.mean(o * o, axis=-1, keepdims=True) + EPS)
    o = o * gla_gain.astype(jnp.float32).reshape(GLA_HEADS, GLA_DVH)
    o = o.reshape(B, L, GLA_DV) * jax.nn.silu(ga.astype(jnp.float32))
    ya = o.astype(dt) @ w_a
    yb = (y_pool * jax.nn.silu(gb.astype(jnp.float32))).astype(dt) @ w_b
    gates = jax.nn.sigmoid(mg.astype(jnp.float32) + b_merge.astype(jnp.float32))
    s_a, s_b = jnp.split(gates, N_BRANCH, axis=-1)
    merged = (s_a * ya.astype(jnp.float32) + s_b * yb.astype(jnp.float32)).astype(dt)
    return h + merged @ w_out, S_new, buf_new


def setup_inputs(seed: int = 0) -> dict:
    key = jax.random.key(seed)
    ks = jax.random.split(key, 18)
    f32 = jnp.float32
    nrm = lambda k, s, sc: jax.random.normal(k, s, f32) * sc
    return {
        "x_prompt": nrm(ks[0], (BATCH, SEQ, D_MODEL), 1.0),
        "x_sample": nrm(ks[1], (DEC_BATCH, DEC_SEQ, D_MODEL), 1.0),
        "state_gla": nrm(ks[2], (DEPTH, DEC_BATCH, GLA_HEADS, GLA_DKH, GLA_DVH), 1.0),
        "state_pool": nrm(ks[3], (DEPTH, DEC_BATCH, POOL_BUF, POOL_WIDTH), 1.0),
        "meta_tokens": nrm(ks[4], (N_META, D_MODEL), 1.0),
        "norm_g": 1.0 + nrm(ks[5], (DEPTH, D_MODEL), 0.02),
        "w_in": nrm(ks[6], (DEPTH, D_MODEL, IN_COLS), D_MODEL ** -0.5),
        "w_alpha": nrm(ks[7], (DEPTH, GATE_RANK, GLA_DK), GATE_RANK ** -0.5),
        "b_alpha": 2.0 + nrm(ks[8], (DEPTH, GLA_DK), 0.5),
        "gla_gain": 1.0 + nrm(ks[9], (DEPTH, GLA_DV), 0.02),
        "w_a": nrm(ks[10], (DEPTH, GLA_DV, D_MODEL), GLA_DV ** -0.5),
        "pool_w": nrm(ks[11], (DEPTH, POOL_GROUPS, POOL_GW, POOL_GW), POOL_GW ** -0.5),
        "pool_scale": 1.0 + nrm(ks[12], (DEPTH, POOL_WIDTH), 0.02),
        "w_b": nrm(ks[13], (DEPTH, POOL_WIDTH, D_MODEL), POOL_WIDTH ** -0.5),
        "b_merge": nrm(ks[14], (DEPTH, N_BRANCH * D_MODEL), 0.02),
        "w_out": nrm(ks[15], (DEPTH, D_MODEL, D_MODEL), D_MODEL ** -0.5),
        "final_norm_g": 1.0 + nrm(ks[16], (D_MODEL,), 0.02),
    }


def reference(x_prompt, x_sample, state_gla, state_pool, meta_tokens, norm_g, w_in, w_alpha,
              b_alpha, gla_gain, w_a, pool_w, pool_scale, w_b, b_merge, w_out, final_norm_g):
    B = x_prompt.shape[0]
    meta = jnp.broadcast_to(meta_tokens[None].astype(x_prompt.dtype), (B, N_META, D_MODEL))
    hp = jnp.concatenate([meta, x_prompt], axis=1)
    hs = x_sample
    sg_p, sp_p, sg_s, sp_s = [], [], [], []
    for l in range(DEPTH):
        lw = (norm_g[l], w_in[l], w_alpha[l], b_alpha[l], gla_gain[l], w_a[l],
              pool_w[l], pool_scale[l], w_b[l], b_merge[l], w_out[l])
        hp, S_p, buf_p = run_layer(hp, True, None, None, *lw)
        hs, S_s, buf_s = run_layer(hs, False, state_gla[l], state_pool[l], *lw)
        sg_p.append(S_p)
        sp_p.append(buf_p)
        sg_s.append(S_s)
        sp_s.append(buf_s)
    y_prompt = rmsnorm(hp[:, N_META:], final_norm_g)
    y_sample = rmsnorm(hs, final_norm_g)
    return (y_prompt, y_sample, jnp.stack(sg_p), jnp.stack(sp_p), jnp.stack(sg_s), jnp.stack(sp_s))
```

```cpp
#include <hip/hip_runtime.h>
#include <cstdio>
#include <cstdint>
namespace pg8 {
#define PG8_LAS __attribute__((address_space(3)))
typedef unsigned short bf16_t;
typedef short bf16x8 __attribute__((ext_vector_type(8)));
typedef float f32x4 __attribute__((ext_vector_type(4)));
typedef unsigned u32x4 __attribute__((ext_vector_type(4)));
constexpr int BM = 256, BK = 64, HALF = 128, HTB = HALF * BK * 2  , STAGE_BYTES = 8 * HTB, NXCD = 8, WGM = 8;

__host__ __device__ __forceinline__ int lds_byte(int r, int c) { const int st = (r >> 4) * 2 + (c >> 5), rr = r & 15, cc = c & 31, ob = rr * 64 + cc * 2; return st * 1024 + (ob ^ (((ob >> 9) & 1) << 5)); }
__host__ __device__ __forceinline__ void stage_rc(int b, int& R, int& C) { const int st = b / 1024, sb = b % 1024, swz = sb ^ (((sb >> 9) & 1) << 5); R = (st >> 1) * 16 + swz / 64; C = (st & 1) * 32 + (swz % 64) / 2; }
__host__ __device__ __forceinline__ int perm32(int rho) { const int n = rho >> 4, i = rho & 15; return 8 * (i >> 2) + 4 * n + (i & 3); }

struct Unit { int pm, pn; };
struct Gemm { const bf16_t* A; const bf16_t* Bt; int M, N, K; };

struct StaticOrder {
    int nM, nN, nwg, G, c;
    __host__ __device__ void init(int M, int N, int G_, int c_) { nM = M / BM; nN = N / BM; nwg = nM * nN; G = G_; c = c_; }
    __host__ __device__ bool next(int i, Unit& u) const {
        const long L = (long)i * G + c; if (L >= nwg) return false;
        int wgid = (int)L; { const int q = nwg / NXCD, r = nwg % NXCD, xcd = wgid % NXCD, off = wgid / NXCD; wgid = (xcd < r ? xcd * (q + 1) : r * (q + 1) + (xcd - r) * q) + off; }
        const int nig = WGM * nN, gid = wgid / nig, fm = gid * WGM, gsz = (nM - fm) < WGM ? (nM - fm) : WGM;
        u.pm = fm + ((wgid % nig) % gsz); u.pn = (wgid % nig) / gsz; return true;
    }
    __device__ __forceinline__ void a_ready(const Unit&) const {}
    __device__ __forceinline__ void done(const Unit&) const {}
};

__device__ __forceinline__ unsigned cvt_pk_bf16(float lo, float hi) { unsigned r; asm volatile("v_cvt_pk_bf16_f32 %0, %1, %2" : "=v"(r) : "v"(lo), "v"(hi)); return r; }
template <class Epi, class Sched, bool ALIGN_EPI = false, bool SP2 = false>
__device__ __forceinline__ void gemm_phase(PG8_LAS unsigned char* lds, const Gemm g, const Sched& S, const Epi& E, const int tid) {
    const int wid = __builtin_amdgcn_readfirstlane(tid >> 6), lane = tid & 63, wr = wid >> 2, wc = wid & 3, fr = lane & 15, fq = lane >> 4;
    const int K = g.K, nt = K / BK;
    unsigned voffA[2], voffB[2];
#pragma unroll
    for (int i = 0; i < 2; ++i) { int R, C; stage_rc(tid * 16 + i * 8192, R, C); const int Rb = Epi::PERM ? ((R & ~31) + perm32(R & 31)) : R;
        voffA[i] = (unsigned)(R * K + C) * 2u; voffB[i] = (unsigned)(Rb * K + C) * 2u; }
    const size_t kstep = (size_t)(BK * 2);
    const size_t hstep = (size_t)HALF * K * 2;
    const size_t tstep = 2 * hstep;
    const unsigned ldsw = (unsigned)wid * 1024u;
    const int aoff = lds_byte(wr * 64 + fr, fq * 8), boff = lds_byte(wc * 32 + fr, fq * 8);
#define PG8_SA(b, h) (((b) * 2 + (h)) * HTB)
#define PG8_SB(b, h) ((4 + (b) * 2 + (h)) * HTB)
#define PG8_STAGE(bufoff, gbase, voff) do { _Pragma("unroll") for (int _i = 0; _i < 2; ++_i) \
        __builtin_amdgcn_global_load_lds((const unsigned*)((const char*)(gbase) + (voff)[_i]), (PG8_LAS unsigned*)(lds + (bufoff) + ldsw + _i * 8192), 16, 0, 0); } while (0)
#define PG8_LDA(dst, b, h) do { _Pragma("unroll") for (int m = 0; m < 4; ++m) _Pragma("unroll") for (int k = 0; k < 2; ++k) dst[m][k] = *(const PG8_LAS bf16x8*)(lds + PG8_SA(b, h) + aoff + m * 2048 + k * 1024); } while (0)
#define PG8_LDB(dst, b, h) do { _Pragma("unroll") for (int n = 0; n < 2; ++n) _Pragma("unroll") for (int k = 0; k < 2; ++k) dst[n][k] = *(const PG8_LAS bf16x8*)(lds + PG8_SB(b, h) + boff + n * 2048 + k * 1024); } while (0)
#define PG8_MMA(ai, bj, At, Bt) do { __builtin_amdgcn_s_setprio(1); _Pragma("unroll") for (int m = 0; m < 4; ++m) _Pragma("unroll") for (int n = 0; n < 2; ++n) _Pragma("unroll") for (int k = 0; k < 2; ++k) \
        acc[ai][bj][m][n] = __builtin_amdgcn_mfma_f32_16x16x32_bf16(Bt[n][k], At[m][k], acc[ai][bj][m][n], 0, 0, 0); __builtin_amdgcn_s_setprio(0); } while (0)
#define PG8_WAIT_V(n) asm volatile("s_waitcnt vmcnt(" #n ")" ::: "memory")
#define PG8_WAIT_L(n) asm volatile("s_waitcnt lgkmcnt(" #n ")" ::: "memory")
#define PG8_BAR __builtin_amdgcn_s_barrier()
#define PG8_SCHED __builtin_amdgcn_sched_barrier(0)
    Unit cur, nxt; int ui = 0;
    if (!S.next(0, cur)) return;
    f32x4 acc[2][2][4][2];
#pragma unroll
    for (int a = 0; a < 2; ++a)
#pragma unroll
        for (int b = 0; b < 2; ++b)
#pragma unroll
            for (int m = 0; m < 4; ++m)
#pragma unroll
                for (int n = 0; n < 2; ++n) acc[a][b][m][n] = (f32x4){0.f, 0.f, 0.f, 0.f};
    bf16x8 At[4][2], B0[2][2], B1[2][2];
    const char* cA = (const char*)g.A + (size_t)cur.pm * tstep; const char* cB = (const char*)g.Bt + (size_t)cur.pn * tstep;
    S.a_ready(cur);
    if constexpr (SP2) {
        PG8_STAGE(PG8_SB(0, 0), cB, voffB); PG8_STAGE(PG8_SB(0, 1), cB + hstep, voffB); PG8_STAGE(PG8_SA(0, 0), cA, voffA); PG8_STAGE(PG8_SA(0, 1), cA + hstep, voffA);
        if (wr == 1) PG8_BAR;
        PG8_WAIT_V(2); PG8_BAR;
        PG8_STAGE(PG8_SB(1, 0), cB + kstep, voffB); PG8_STAGE(PG8_SA(1, 0), cA + kstep, voffA); PG8_STAGE(PG8_SB(1, 1), cB + hstep + kstep, voffB);
        PG8_WAIT_V(6); PG8_BAR;
    } else {
        PG8_STAGE(PG8_SB(0, 0), cB, voffB); PG8_STAGE(PG8_SA(0, 0), cA, voffA); PG8_STAGE(PG8_SB(0, 1), cB + hstep, voffB); PG8_STAGE(PG8_SA(0, 1), cA + hstep, voffA);
        if (wr == 1) PG8_BAR;
        PG8_WAIT_V(4); PG8_BAR;
        PG8_STAGE(PG8_SB(1, 0), cB + kstep, voffB); PG8_STAGE(PG8_SA(1, 0), cA + kstep, voffA); PG8_STAGE(PG8_SB(1, 1), cB + hstep + kstep, voffB);
        PG8_WAIT_V(6); PG8_BAR;
    }
    for (;;) {
        const bool has_next = S.next(ui + 1, nxt);
        const char* nA = has_next ? (const char*)g.A + (size_t)nxt.pm * tstep : cA; const char* nB = has_next ? (const char*)g.Bt + (size_t)nxt.pn * tstep : cB;
        for (int t = 0; t < nt; t += 2) {
            const bool last = (t == nt - 2);
            const char* a1 = cA + (size_t)(t + 1) * kstep;
            const char* a2 = last ? nA : cA + (size_t)(t + 2) * kstep; const char* b2 = last ? nB : cB + (size_t)(t + 2) * kstep;
            const char* a3 = a2 + kstep; const char* b3 = b2 + kstep;
            if (last && has_next) S.a_ready(nxt);
            if constexpr (SP2) {
            PG8_LDB(B0, 0, 0); PG8_LDB(B1, 0, 1); PG8_SCHED; PG8_LDA(At, 0, 0); PG8_STAGE(PG8_SA(1, 1), a1 + hstep, voffA);
            PG8_WAIT_V(8); PG8_WAIT_L(0); PG8_BAR; PG8_MMA(0, 0, At, B0); PG8_MMA(0, 1, At, B1); PG8_BAR; PG8_SCHED;
            PG8_LDA(At, 0, 1); PG8_STAGE(PG8_SB(0, 0), b2, voffB); PG8_STAGE(PG8_SB(0, 1), b2 + hstep, voffB); PG8_STAGE(PG8_SA(0, 0), a2, voffA);
            PG8_WAIT_V(8); PG8_WAIT_L(0); PG8_BAR; PG8_MMA(1, 0, At, B0); PG8_MMA(1, 1, At, B1); PG8_BAR; PG8_SCHED;
            PG8_LDB(B0, 1, 0); PG8_LDB(B1, 1, 1); PG8_SCHED; PG8_LDA(At, 1, 0); PG8_STAGE(PG8_SA(0, 1), a2 + hstep, voffA);
            PG8_WAIT_V(8); PG8_WAIT_L(0); PG8_BAR; PG8_MMA(0, 0, At, B0); PG8_MMA(0, 1, At, B1); PG8_BAR; PG8_SCHED;
            PG8_LDA(At, 1, 1); PG8_STAGE(PG8_SB(1, 0), b3, voffB); PG8_STAGE(PG8_SB(1, 1), b3 + hstep, voffB); PG8_STAGE(PG8_SA(1, 0), a3, voffA);
            PG8_WAIT_V(8); PG8_WAIT_L(0); PG8_BAR; PG8_MMA(1, 0, At, B0); PG8_MMA(1, 1, At, B1); PG8_BAR; PG8_SCHED;
            } else {
            PG8_LDB(B0, 0, 0); PG8_SCHED; PG8_LDA(At, 0, 0); PG8_STAGE(PG8_SA(1, 1), a1 + hstep, voffA);
            PG8_WAIT_L(8); PG8_BAR; PG8_WAIT_L(0); PG8_MMA(0, 0, At, B0); PG8_BAR; PG8_SCHED;
            PG8_LDB(B1, 0, 1); PG8_STAGE(PG8_SB(0, 0), b2, voffB);
            PG8_BAR; PG8_WAIT_L(0); PG8_MMA(0, 1, At, B1); PG8_BAR;
            PG8_LDA(At, 0, 1); PG8_STAGE(PG8_SA(0, 0), a2, voffA);
            PG8_BAR; PG8_WAIT_L(0); PG8_MMA(1, 0, At, B0); PG8_BAR; PG8_SCHED;
            PG8_STAGE(PG8_SB(0, 1), b2 + hstep, voffB);
            PG8_WAIT_V(6); PG8_BAR; PG8_MMA(1, 1, At, B1); PG8_BAR;
            PG8_LDB(B0, 1, 0); PG8_SCHED; PG8_LDA(At, 1, 0); PG8_STAGE(PG8_SA(0, 1), a2 + hstep, voffA);
            PG8_WAIT_L(8); PG8_BAR; PG8_WAIT_L(0); PG8_MMA(0, 0, At, B0); PG8_BAR; PG8_SCHED;
            PG8_LDB(B1, 1, 1); PG8_STAGE(PG8_SB(1, 0), b3, voffB);
            PG8_BAR; PG8_WAIT_L(0); PG8_MMA(0, 1, At, B1); PG8_BAR;
            PG8_LDA(At, 1, 1); PG8_STAGE(PG8_SA(1, 0), a3, voffA);
            PG8_BAR; PG8_WAIT_L(0); PG8_MMA(1, 0, At, B0); PG8_BAR; PG8_SCHED;
            PG8_STAGE(PG8_SB(1, 1), b3 + hstep, voffB);
            PG8_WAIT_V(6); PG8_BAR; PG8_MMA(1, 1, At, B1); PG8_BAR;
            }
        }
        if constexpr (ALIGN_EPI) { if (wr == 0) PG8_BAR; }
        if constexpr (!Epi::AFTER_DRAIN) { E(acc, cur, wr, wc, fr, fq); S.done(cur); }
        if (!has_next) break;
#pragma unroll
        for (int a = 0; a < 2; ++a)
#pragma unroll
            for (int b = 0; b < 2; ++b)
#pragma unroll
                for (int m = 0; m < 4; ++m)
#pragma unroll
                    for (int n = 0; n < 2; ++n) acc[a][b][m][n] = (f32x4){0.f, 0.f, 0.f, 0.f};
        cur = nxt; cA = nA; cB = nB; ++ui;
        if constexpr (ALIGN_EPI) { if (wr == 1) PG8_BAR; }
    }
    PG8_WAIT_V(0);
    if constexpr (!ALIGN_EPI) { if (wr == 0) PG8_BAR; }
    PG8_BAR;
    if constexpr (Epi::AFTER_DRAIN) { E.fused(acc, cur, wr, wc, fr, fq, lds, wid, lane); S.done(cur); }
#undef PG8_SA
#undef PG8_SB
#undef PG8_STAGE
#undef PG8_LDA
#undef PG8_LDB
#undef PG8_MMA
#undef PG8_WAIT_V
#undef PG8_WAIT_L
#undef PG8_BAR
#undef PG8_SCHED
}
}

#define LAS __attribute__((address_space(3)))
typedef unsigned short bf16;
typedef short bf16x8 __attribute__((ext_vector_type(8)));
typedef float f32x4 __attribute__((ext_vector_type(4)));
typedef unsigned u32x4 __attribute__((ext_vector_type(4)));
typedef unsigned u32x2 __attribute__((ext_vector_type(2)));

constexpr int NWAVES = 8, NTHR = 512;
constexpr int DM = 1024, NBATCH = 8, SEQ = 2048, DEPTH = 2, NSMP = 128;
constexpr int INC = 6160;
constexpr int R_SMP = 16384, R_META = 16896, R_REAL = 16912, R = 17152;
constexpr int NZ = 6400;
constexpr int ZQ = 0, ZK = 512, ZV = 1024, ZGA = 2048, ZU = 3072, ZGB = 3584, ZMG = 4096, ZAL = 6144;
constexpr float EPS = 1e-6f, QSCALE = 0.08838834764831845f;
constexpr int N_GATE_ITEMS = 260;
constexpr int N_POOL_ITEMS = 548;
constexpr int N_SMP_ITEMS = 512;

constexpr size_t O_YP = 0, O_YS = 16777216, O_SGP = 17301504, O_SPP = 19398656, O_SGS = 19521536, O_SPS = 53075968, O_END = 55042048;

constexpr size_t WS_CTL = 0, CTL_BYTES = 1u << 20;
constexpr size_t WS_WIN = WS_CTL + CTL_BYTES;
constexpr size_t WS_WA = WS_WIN + (size_t)2 * NZ * DM * 2;
constexpr size_t WS_WB = WS_WA + (size_t)2 * DM * DM * 2;
constexpr size_t WS_WO = WS_WB + (size_t)2 * DM * 512 * 2;
constexpr size_t WS_PWT = WS_WO + (size_t)2 * DM * DM * 2;
constexpr size_t WS_HB = WS_PWT + (size_t)2 * 4 * 128 * 128 * 2;
constexpr size_t WS_Z = WS_HB + (size_t)R * DM * 2;
constexpr size_t WS_QT = WS_Z + (size_t)R * NZ * 2;
constexpr size_t WS_KT = WS_QT + (size_t)R * 512 * 2;
constexpr size_t WS_VT = WS_KT + (size_t)R * 512 * 2;
constexpr size_t WS_UT = WS_VT + (size_t)4 * 256 * R * 2;
constexpr size_t WS_DG = WS_UT + (size_t)N_GATE_ITEMS * 256 * 128 * 2;
constexpr size_t WS_AIN = WS_DG + (size_t)N_GATE_ITEMS * 128 * 4;
constexpr size_t WS_BIN = WS_AIN + (size_t)R * DM * 2;
constexpr size_t WS_MRG = WS_BIN + (size_t)R * 512 * 2;
constexpr size_t WS_SS = WS_MRG + (size_t)R * DM * 2;
constexpr size_t WS_END = WS_SS + (size_t)3 * R * 16 * 4;
static_assert(WS_END < ((size_t)500 << 20), "workspace map");
static_assert(WS_WIN % 256 == 0 && WS_HB % 256 == 0 && WS_Z % 256 == 0 && WS_VT % 256 == 0 && WS_UT % 256 == 0 && WS_DG % 256 == 0 && WS_AIN % 256 == 0 && WS_SS % 256 == 0, "alignment");

constexpr int LDS_BYTES = 163840;
constexpr int LDS_CTL_OFF = LDS_BYTES - 256;
constexpr int N_PHASES = 12;

__device__ __forceinline__ float bflo(unsigned w) { return __uint_as_float(w << 16); }
__device__ __forceinline__ float bfhi(unsigned w) { return __uint_as_float(w & 0xffff0000u); }
__device__ __forceinline__ float bf2f(bf16 u) { return __uint_as_float((unsigned)u << 16); }
__device__ __forceinline__ bf16 f2bf(float f) { unsigned u = __float_as_uint(f); return (bf16)((u + 0x7fffu + ((u >> 16) & 1u)) >> 16); }
typedef __bf16 bf16x2_t __attribute__((ext_vector_type(2)));
typedef float f32x2_t __attribute__((ext_vector_type(2)));
__device__ __forceinline__ unsigned pk2(float lo, float hi) { f32x2_t v = {lo, hi}; bf16x2_t b = __builtin_convertvector(v, bf16x2_t); return __builtin_bit_cast(unsigned, b); }
__device__ __forceinline__ float sigmoidf_(float x) { return __builtin_amdgcn_rcpf(1.0f + __expf(-x)); }
__device__ __forceinline__ float siluf_(float x) { return x * sigmoidf_(x); }
__device__ __forceinline__ float logsig16(float x) { return (fminf(x, 0.f) - __logf(1.0f + __expf(-fabsf(x)))) * 0.0625f; }
#define LDS_WAIT() asm volatile("s_waitcnt lgkmcnt(0)" ::: "memory")
__device__ __forceinline__ float ss_sum16(const float* p) { const f32x4 a = *(const f32x4*)p, b = *(const f32x4*)(p + 4), c = *(const f32x4*)(p + 8), d = *(const f32x4*)(p + 12);
    return (((a[0] + a[1]) + (a[2] + a[3])) + ((b[0] + b[1]) + (b[2] + b[3]))) + (((c[0] + c[1]) + (c[2] + c[3])) + ((d[0] + d[1]) + (d[2] + d[3]))); }

template <int MT, int NT, int KS>
__device__ __forceinline__ void lds_mma(f32x4 (&acc)[MT][NT], const LAS unsigned char* a, int sa, const LAS unsigned char* b, int sb, int lane) {
    const int fr = lane & 15, fq = lane >> 4;
    const LAS unsigned char* ap = a + fr * sa + fq * 16;
    const LAS unsigned char* bp = b + fr * sb + fq * 16;
#pragma unroll
    for (int ks = 0; ks < KS; ++ks) {
        bf16x8 af[MT], bfr[NT];
#pragma unroll
        for (int m = 0; m < MT; ++m) af[m] = *(const LAS bf16x8*)(ap + m * 16 * sa + ks * 64);
#pragma unroll
        for (int n = 0; n < NT; ++n) bfr[n] = *(const LAS bf16x8*)(bp + n * 16 * sb + ks * 64);
#pragma unroll
        for (int m = 0; m < MT; ++m)
#pragma unroll
            for (int n = 0; n < NT; ++n) acc[m][n] = __builtin_amdgcn_mfma_f32_16x16x32_bf16(af[m], bfr[n], acc[m][n], 0, 0, 0);
    }
}

#define XB_TMO      128
#define XB_XCNT(j)  (256  + 64 * (j))
#define XB_XSUB(j)  (1280 + 64 * (j))
#define XB_XGEN(j)  (2304 + 64 * (j))
#define XB_TOP      3328
#define XB_TOPGEN   3392
#define XCD_BAR_WORDS 3456
#define XB_SPIN_CAP (1u << 18)
__device__ __forceinline__ unsigned xb_ld(unsigned* p)              { return __hip_atomic_load(p, __ATOMIC_RELAXED, __HIP_MEMORY_SCOPE_AGENT); }
__device__ __forceinline__ unsigned xb_add(unsigned* p, unsigned v) { return __hip_atomic_fetch_add(p, v, __ATOMIC_RELAXED, __HIP_MEMORY_SCOPE_AGENT); }
__device__ __forceinline__ unsigned xb_xcc_id() { return (unsigned)__builtin_amdgcn_s_getreg((3 << 11) | 20) & 0xFu; }
#define XB_SPIN(cond, bar) do { unsigned _sp = 0; while (cond) { __builtin_amdgcn_s_sleep(1); \
    if ((++_sp & 255u) == 0u) { if (xb_ld(&(bar)[XB_TMO])) break; if (_sp > XB_SPIN_CAP) { atomicAdd(&(bar)[XB_TMO], 1u); break; } } } } while (0)
struct XcdBarrier { unsigned* bar; unsigned x; volatile LAS unsigned* st; };
__device__ __forceinline__ XcdBarrier xcd_barrier_post(unsigned* bar, volatile LAS unsigned* st) {
    XcdBarrier b; b.bar = bar; b.x = xb_xcc_id(); b.st = st;
    if (threadIdx.x == 0) (void)xb_add(&bar[XB_XCNT(b.x)], 1u);
    return b;
}
__device__ __forceinline__ void xcd_barrier_complete(unsigned* bar, unsigned x, unsigned& nloc, unsigned& nx) {
    const unsigned G = gridDim.x * gridDim.y * gridDim.z;
    unsigned sum, cnt, mine, sp = 0u;
    for (;;) {
        sum = 0u; cnt = 0u; mine = 0u;
#pragma unroll
        for (unsigned j = 0; j < 16; ++j) { const unsigned c = xb_ld(&bar[XB_XCNT(j)]); sum += c; cnt += (c > 0u) ? 1u : 0u; mine = (j == x) ? c : mine; }
        if (sum == G) break;
        __builtin_amdgcn_s_sleep(1);
        if ((++sp & 255u) == 0u) { if (xb_ld(&bar[XB_TMO])) break; if (sp > XB_SPIN_CAP) { atomicAdd(&bar[XB_TMO], 1u); break; } }
    }
    nloc = mine > 0u ? mine : 1u; nx = cnt > 0u ? cnt : 1u;
}
__device__ __forceinline__ void xcd_barrier(const XcdBarrier& b) {
    asm volatile("s_waitcnt vmcnt(0)" ::: "memory");
    __syncthreads();
    if (threadIdx.x == 0) {
        unsigned* bar = b.bar;
        __builtin_amdgcn_s_waitcnt(0);
        unsigned nloc = b.st[0], nx = b.st[1];
        if (nloc == 0u) { xcd_barrier_complete(bar, b.x, nloc, nx); b.st[0] = nloc; b.st[1] = nx; }
        const unsigned old = xb_add(&bar[XB_XSUB(b.x)], 1u);
        const unsigned gen = old / nloc;
        if (old + 1u == (gen + 1u) * nloc) {
            __builtin_amdgcn_fence(__ATOMIC_RELEASE, "agent");
            asm volatile("s_waitcnt vmcnt(0)" ::: "memory");
            const unsigned og = xb_add(&bar[XB_TOP], 1u);
            const unsigned tg = og / nx;
            if (og + 1u == (tg + 1u) * nx) xb_add(&bar[XB_TOPGEN], 1u);
            else XB_SPIN(xb_ld(&bar[XB_TOPGEN]) == tg, bar);
            __builtin_amdgcn_fence(__ATOMIC_ACQUIRE, "agent");
            xb_add(&bar[XB_XGEN(b.x)], 1u);
            asm volatile("s_waitcnt vmcnt(0)" ::: "memory");
        } else {
            XB_SPIN(xb_ld(&bar[XB_XGEN(b.x)]) == gen, bar);
            __builtin_amdgcn_fence(__ATOMIC_ACQUIRE, "agent");
            asm volatile("s_waitcnt vmcnt(0)" ::: "memory");
        }
    }
    __syncthreads();
}

struct Args { const float* in[17]; float* out; unsigned char* ws; int ph_lo, ph_hi; };
enum { I_XP = 0, I_XS, I_SG, I_SP, I_META, I_NG, I_WIN, I_WAL, I_BAL, I_GAIN, I_WA, I_PW, I_PSC, I_WB, I_BM, I_WO, I_FG };

struct EpiZ {
    static constexpr bool PERM = true, AFTER_DRAIN = false;
    bf16* O; const float* ss;
    __device__ __forceinline__ void operator()(const f32x4 (&acc)[2][2][4][2], const pg8::Unit& u, int wr, int wc, int fr, int fq) const {
        const int row0 = u.pm * 256 + wr * 64 + fr, col0 = u.pn * 256 + wc * 32 + 8 * fq;
#pragma unroll
        for (int ai = 0; ai < 2; ++ai)
#pragma unroll
            for (int m = 0; m < 4; ++m) { const int row = row0 + ai * 128 + m * 16; const float rs = __builtin_amdgcn_rsqf(ss_sum16(ss + (size_t)row * 16) * (1.0f / 1024.0f) + EPS);
                bf16* rowp = O + (size_t)row * NZ + col0;
#pragma unroll
                for (int bj = 0; bj < 2; ++bj) { const f32x4 v0 = acc[ai][bj][m][0] * rs, v1 = acc[ai][bj][m][1] * rs;
                    u32x4 w; w.x = pk2(v0[0], v0[1]); w.y = pk2(v0[2], v0[3]); w.z = pk2(v1[0], v1[1]); w.w = pk2(v1[2], v1[3]);
                    *(u32x4*)(rowp + bj * 128) = w; } }
    }
};
template <bool SECOND> struct EpiGate {
    static constexpr bool PERM = true, AFTER_DRAIN = false;
    const bf16* z; const float* bm; bf16* mrg;
    __device__ __forceinline__ void operator()(const f32x4 (&acc)[2][2][4][2], const pg8::Unit& u, int wr, int wc, int fr, int fq) const {
        const int row0 = u.pm * 256 + wr * 64 + fr, col0 = u.pn * 256 + wc * 32 + 8 * fq, goff = SECOND ? 1024 : 0;
#pragma unroll
        for (int bj = 0; bj < 2; ++bj) { const int col = col0 + bj * 128;
            const f32x4 b0 = *(const f32x4*)(bm + goff + col), b1 = *(const f32x4*)(bm + goff + col + 4);
#pragma unroll
            for (int ai = 0; ai < 2; ++ai)
#pragma unroll
                for (int m = 0; m < 4; ++m) { const int row = row0 + ai * 128 + m * 16;
                    const u32x4 g = *(const u32x4*)(z + (size_t)row * NZ + ZMG + goff + col);
                    f32x4 v0 = acc[ai][bj][m][0], v1 = acc[ai][bj][m][1];
                    v0[0] *= sigmoidf_(bflo(g.x) + b0[0]); v0[1] *= sigmoidf_(bfhi(g.x) + b0[1]); v0[2] *= sigmoidf_(bflo(g.y) + b0[2]); v0[3] *= sigmoidf_(bfhi(g.y) + b0[3]);
                    v1[0] *= sigmoidf_(bflo(g.z) + b1[0]); v1[1] *= sigmoidf_(bfhi(g.z) + b1[1]); v1[2] *= sigmoidf_(bflo(g.w) + b1[2]); v1[3] *= sigmoidf_(bfhi(g.w) + b1[3]);
                    bf16* p = mrg + (size_t)row * DM + col;
                    if (SECOND) { const u32x4 o = *(const u32x4*)p;
                        v0[0] += bflo(o.x); v0[1] += bfhi(o.x); v0[2] += bflo(o.y); v0[3] += bfhi(o.y); v1[0] += bflo(o.z); v1[1] += bfhi(o.z); v1[2] += bflo(o.w); v1[3] += bfhi(o.w); }
                    u32x4 w; w.x = pk2(v0[0], v0[1]); w.y = pk2(v0[2], v0[3]); w.z = pk2(v1[0], v1[1]); w.w = pk2(v1[2], v1[3]);
                    *(u32x4*)p = w;
                    asm volatile("" ::: "memory"); } }
    }
};
struct EpiOut {
    static constexpr bool PERM = true, AFTER_DRAIN = false;
    bf16* hb; float* ssn;
    __device__ __forceinline__ void operator()(const f32x4 (&acc)[2][2][4][2], const pg8::Unit& u, int wr, int wc, int fr, int fq) const {
        const int row0 = u.pm * 256 + wr * 64 + fr, col0 = u.pn * 256 + wc * 32 + 8 * fq;
#pragma unroll
        for (int ai = 0; ai < 2; ++ai)
#pragma unroll
            for (int m = 0; m < 4; ++m) { const int row = row0 + ai * 128 + m * 16; float s = 0.f;
#pragma unroll
                for (int bj = 0; bj < 2; ++bj) { bf16* p = hb + (size_t)row * DM + col0 + bj * 128; const u32x4 o = *(const u32x4*)p;
                    f32x4 v0 = acc[ai][bj][m][0], v1 = acc[ai][bj][m][1];
                    v0[0] += bflo(o.x); v0[1] += bfhi(o.x); v0[2] += bflo(o.y); v0[3] += bfhi(o.y); v1[0] += bflo(o.z); v1[1] += bfhi(o.z); v1[2] += bflo(o.w); v1[3] += bfhi(o.w);
                    s += (v0[0] * v0[0] + v0[1] * v0[1]) + (v0[2] * v0[2] + v0[3] * v0[3]) + (v1[0] * v1[0] + v1[1] * v1[1]) + (v1[2] * v1[2] + v1[3] * v1[3]);
                    u32x4 w; w.x = pk2(v0[0], v0[1]); w.y = pk2(v0[2], v0[3]); w.z = pk2(v1[0], v1[1]); w.w = pk2(v1[2], v1[3]);
                    *(u32x4*)p = w; }
                s += __shfl_xor(s, 16); s += __shfl_xor(s, 32);
                if (fq == 0) ssn[(size_t)row * 16 + u.pn * 4 + wc] = s; }
    }
};

__device__ __forceinline__ int win_src_col(int n) { return n < 4096 ? n : (n < 6144 ? n + 16 : (n < 6160 ? n - 2048 : -1)); }
template <bool WIN>
__device__ __forceinline__ void p0_transpose_item(const float* W, int ldw, int K, bf16* WT, const float* gk, LAS float* scr, int kb, int nb, int lane) {
    const int k0 = 64 * kb, n0 = 32 * nb;
    const int n = n0 + (lane & 31); const int sc = WIN ? win_src_col(n) : n;
#pragma unroll 8
    for (int i = 0; i < 32; ++i) { const int kk = 2 * i + (lane >> 5); float v = 0.f;
        if (sc >= 0) { v = W[(size_t)(k0 + kk) * ldw + sc]; if (WIN) v *= gk[k0 + kk]; }
        scr[kk * 33 + (lane & 31)] = v; }
    LDS_WAIT(); asm volatile("" ::: "memory");
    const int c = lane & 7;
#pragma unroll
    for (int j = 0; j < 4; ++j) { const int nn = (lane >> 3) + 8 * j; const LAS float* s = scr + (8 * c) * 33 + nn;
        u32x4 o; o.x = pk2(s[0 * 33], s[1 * 33]); o.y = pk2(s[2 * 33], s[3 * 33]); o.z = pk2(s[4 * 33], s[5 * 33]); o.w = pk2(s[6 * 33], s[7 * 33]);
        *(u32x4*)(WT + (size_t)(n0 + nn) * K + k0 + 8 * c) = o; }
    LDS_WAIT(); asm volatile("" ::: "memory");
}
__device__ __forceinline__ void p0_prologue(const Args& A, unsigned char* ws, LAS unsigned char* lds, int tid, int lane, int wave) {
    LAS float* scr = (LAS float*)(lds + wave * 16384);
    const int gw = blockIdx.x * NWAVES + wave, NGW = gridDim.x * NWAVES;
    constexpr int I_IN = 16 * 200, I_A = 16 * 32, I_B = 8 * 32, I_O = 16 * 32, I_P = 32, I_L = I_IN + I_A + I_B + I_O + I_P;
    for (int it = gw; it < 2 * I_L; it += NGW) {
        const int l = it / I_L; int r = it % I_L;
        if (r < I_IN) { p0_transpose_item<true>(A.in[I_WIN] + (size_t)l * DM * INC, INC, DM, (bf16*)(ws + WS_WIN) + (size_t)l * NZ * DM, A.in[I_NG] + l * DM, scr, r / 200, r % 200, lane); continue; } r -= I_IN;
        if (r < I_A) { p0_transpose_item<false>(A.in[I_WA] + (size_t)l * DM * DM, DM, DM, (bf16*)(ws + WS_WA) + (size_t)l * DM * DM, nullptr, scr, r / 32, r % 32, lane); continue; } r -= I_A;
        if (r < I_B) { p0_transpose_item<false>(A.in[I_WB] + (size_t)l * 512 * DM, DM, 512, (bf16*)(ws + WS_WB) + (size_t)l * DM * 512, nullptr, scr, r / 32, r % 32, lane); continue; } r -= I_B;
        if (r < I_O) { p0_transpose_item<false>(A.in[I_WO] + (size_t)l * DM * DM, DM, DM, (bf16*)(ws + WS_WO) + (size_t)l * DM * DM, nullptr, scr, r / 32, r % 32, lane); continue; } r -= I_O;
        { const int g = r >> 3, rr = r & 7;
          p0_transpose_item<false>(A.in[I_PW] + (size_t)(l * 4 + g) * 128 * 128, 128, 128, (bf16*)(ws + WS_PWT) + (size_t)(l * 4 + g) * 128 * 128, nullptr, scr, rr >> 2, rr & 3, lane); }
    }
    bf16* hb = (bf16*)(ws + WS_HB); float* ss = (float*)(ws + WS_SS);
    for (int row = gw; row < R; row += NGW) {
        f32x4 v[4]; float s = 0.f;
        if (row < R_REAL) {
            const float* src = row < R_SMP ? A.in[I_XP] + (size_t)row * DM : (row < R_META ? A.in[I_XS] + (size_t)(row - R_SMP) * DM : A.in[I_META] + (size_t)(row - R_META) * DM);
#pragma unroll
            for (int j = 0; j < 4; ++j) { v[j] = *(const f32x4*)(src + 4 * lane + 256 * j); s += (v[j][0] * v[j][0] + v[j][1] * v[j][1]) + (v[j][2] * v[j][2] + v[j][3] * v[j][3]); }
        } else {
#pragma unroll
            for (int j = 0; j < 4; ++j) v[j] = (f32x4){0.f, 0.f, 0.f, 0.f};
        }
#pragma unroll
        for (int o = 1; o < 64; o <<= 1) s += __shfl_xor(s, o);
#pragma unroll
        for (int j = 0; j < 4; ++j) { u32x2 w; w.x = pk2(v[j][0], v[j][1]); w.y = pk2(v[j][2], v[j][3]); *(u32x2*)(hb + (size_t)row * DM + 4 * lane + 256 * j) = w; }
        if (lane < 16) ss[(size_t)row * 16 + lane] = (lane == 0) ? s : 0.f;
    }
}

__device__ __forceinline__ void p2_gate_item(const Args& A, unsigned char* ws, LAS unsigned char* lds, int l, int item, int tid, int lane, int wave) {
    const bf16* z = (const bf16*)(ws + WS_Z); bf16* qt = (bf16*)(ws + WS_QT); bf16* kt = (bf16*)(ws + WS_KT); bf16* vtg = (bf16*)(ws + WS_VT);
    bf16* UT = (bf16*)(ws + WS_UT); float* Dg = (float*)(ws + WS_DG);
    const int rt = item >> 2, h = item & 3; const bool meta = (rt == 64);
    const int row0 = meta ? R_META : rt * 256, nrows = meta ? 16 : 256;
    constexpr int ALW = 0, SEG = 8192, KDT = 10240, VTL = 77824, SROW = 528;
    { const int row = tid >> 1, half = tid & 1; u32x4 v = (u32x4){0u, 0u, 0u, 0u};
      if (row < nrows) v = *(const u32x4*)(z + (size_t)(row0 + row) * NZ + ZAL + half * 8);
      *(LAS u32x4*)(lds + ALW + row * 32 + half * 16) = v; }
    __syncthreads();
    const int d = tid & 127, sg = __builtin_amdgcn_readfirstlane(tid >> 7), col = h * 128 + d;
    float wa[16];
#pragma unroll
    for (int r = 0; r < 16; ++r) wa[r] = A.in[I_WAL][(size_t)(l * 16 + r) * 512 + col];
    const float ba = A.in[I_BAL][l * 512 + col];
    int nloc = nrows - sg * 64; nloc = nloc < 0 ? 0 : (nloc > 64 ? 64 : nloc);
    float la[64]; float run = 0.f;
#pragma unroll
    for (int i = 0; i < 64; ++i) { float v = 0.f;
        if (i < nloc) { const int row = sg * 64 + i; const u32x4 a0 = *(const LAS u32x4*)(lds + ALW + row * 32), a1 = *(const LAS u32x4*)(lds + ALW + row * 32 + 16);
            float x = ba;
            x += bflo(a0.x) * wa[0]; x += bfhi(a0.x) * wa[1]; x += bflo(a0.y) * wa[2]; x += bfhi(a0.y) * wa[3]; x += bflo(a0.z) * wa[4]; x += bfhi(a0.z) * wa[5]; x += bflo(a0.w) * wa[6]; x += bfhi(a0.w) * wa[7];
            x += bflo(a1.x) * wa[8]; x += bfhi(a1.x) * wa[9]; x += bflo(a1.y) * wa[10]; x += bfhi(a1.y) * wa[11]; x += bflo(a1.z) * wa[12]; x += bfhi(a1.z) * wa[13]; x += bflo(a1.w) * wa[14]; x += bfhi(a1.w) * wa[15];
            v = logsig16(x); }
        la[i] = v; run += v; }
    ((LAS float*)(lds + SEG))[sg * 128 + d] = run;
    __syncthreads();
    float off = 0.f, tot = 0.f;
#pragma unroll
    for (int s = 0; s < 4; ++s) { const float t = ((const LAS float*)(lds + SEG))[s * 128 + d]; tot += t; if (s < sg) off += t; }
    const float Dd = __expf(tot);
    if (sg == 0) Dg[(size_t)item * 128 + d] = Dd;
    float Bc = off;
#pragma unroll
    for (int i8 = 0; i8 < 8; ++i8) { float kdv[8];
#pragma unroll
        for (int ii = 0; ii < 8; ++ii) { const int i = i8 * 8 + ii; kdv[ii] = 0.f;
            if (i < nloc) { const size_t grow = (size_t)(row0 + sg * 64 + i);
                Bc += la[i]; const float eB = __expf(Bc), ie = __builtin_amdgcn_rcpf(eB);
                const float q = bf2f(z[grow * NZ + ZQ + col]), k = bf2f(z[grow * NZ + ZK + col]);
                qt[grow * 512 + col] = f2bf(q * eB * QSCALE); const float kk = k * ie; kt[grow * 512 + col] = f2bf(kk); kdv[ii] = kk * Dd; } }
        u32x4 w; w.x = pk2(kdv[0], kdv[1]); w.y = pk2(kdv[2], kdv[3]); w.z = pk2(kdv[4], kdv[5]); w.w = pk2(kdv[6], kdv[7]);
        *(LAS u32x4*)(lds + KDT + d * SROW + (sg * 64 + i8 * 8) * 2) = w; }
    const int fr = lane & 15, fq = lane >> 4, wm = wave >> 2, wn = wave & 3;
#ifndef GATE_HV
#define GATE_HV 2
#endif
#pragma unroll 1
    for (int hv = 0; hv < GATE_HV; ++hv) {
        { const int tb = 8 * (wave & 3) + (lane & 7), vb = 8 * (wave >> 2) + (lane >> 3), t0 = 8 * tb, v0 = 8 * vb;
          u32x4 rr[8];
#pragma unroll
          for (int i = 0; i < 8; ++i) { rr[i] = (u32x4){0u, 0u, 0u, 0u}; if (t0 + i < nrows) rr[i] = *(const u32x4*)(z + (size_t)(row0 + t0 + i) * NZ + ZV + h * 256 + hv * 128 + v0); }
#pragma unroll
          for (int c = 0; c < 8; ++c) { const int p = c >> 1; u32x4 o;
#pragma unroll
              for (int k = 0; k < 4; ++k) { const unsigned a = rr[2 * k][p], b = rr[2 * k + 1][p]; o[k] = (c & 1) ? ((a >> 16) | (b & 0xffff0000u)) : ((a & 0xffffu) | (b << 16)); }
              *(LAS u32x4*)(lds + VTL + (v0 + c) * SROW + t0 * 2) = o; } }
        __syncthreads();
#ifndef GATE_SKIP
#define GATE_SKIP 0
#endif
        if (!(GATE_SKIP & 1)) {
        f32x4 acc[4][2];
#pragma unroll
        for (int m = 0; m < 4; ++m)
#pragma unroll
            for (int n = 0; n < 2; ++n) acc[m][n] = (f32x4){0.f, 0.f, 0.f, 0.f};
        lds_mma<4, 2, 8>(acc, lds + KDT + (64 * wm) * SROW, SROW, lds + VTL + (32 * wn) * SROW, SROW, lane);
#pragma unroll
        for (int m = 0; m < 4; ++m)
#pragma unroll
            for (int n = 0; n < 2; ++n) { const int dd = 64 * wm + 16 * m + 4 * fq, vv = 32 * wn + 16 * n + fr;
                u32x2 w; w.x = pk2(acc[m][n][0], acc[m][n][1]); w.y = pk2(acc[m][n][2], acc[m][n][3]);
                *(u32x2*)(UT + ((size_t)item * 256 + hv * 128 + vv) * 128 + dd) = w; }
        }
        if (!(GATE_SKIP & 2)) { const int ncht = meta ? 2 : 32;
          for (int idx = tid; idx < 128 * ncht; idx += NTHR) { const int vv = idx / ncht, c = idx % ncht;
              const u32x4 val = *(const LAS u32x4*)(lds + VTL + vv * SROW + c * 16);
              *(u32x4*)(vtg + (size_t)(h * 256 + hv * 128 + vv) * R + row0 + c * 8) = val; } }
        __syncthreads();
    }
}

__device__ __forceinline__ void p2_sample_item(const Args& A, unsigned char* ws, LAS unsigned char* lds, int l, int item, int tid, int lane, int wave) {
    const bf16* z = (const bf16*)(ws + WS_Z); bf16* ain = (bf16*)(ws + WS_AIN);
    const int s = item >> 2, h = item & 3, rowb = R_SMP + 4 * s;
    LAS float* EQ = (LAS float*)(lds + 0); LAS float* KD = (LAS float*)(lds + 2048); LAS float* DD = (LAS float*)(lds + 4096); LAS float* AMP = (LAS float*)(lds + 4608);
    LAS float* VV = (LAS float*)(lds + 5120); LAS float* OACC = (LAS float*)(lds + 9216); LAS float* RSS = (LAS float*)(lds + 41984);
    if (tid < 128) { const int d = tid, col = h * 128 + d;
        float wa[16];
#pragma unroll
        for (int r = 0; r < 16; ++r) wa[r] = A.in[I_WAL][(size_t)(l * 16 + r) * 512 + col];
        const float ba = A.in[I_BAL][l * 512 + col];
        float Bt[4], q[4], k[4]; float run = 0.f;
#pragma unroll
        for (int t = 0; t < 4; ++t) { const bf16* ar = z + (size_t)(rowb + t) * NZ + ZAL; const u32x4 a0 = *(const u32x4*)ar, a1 = *(const u32x4*)(ar + 8);
            float x = ba;
            x += bflo(a0.x) * wa[0]; x += bfhi(a0.x) * wa[1]; x += bflo(a0.y) * wa[2]; x += bfhi(a0.y) * wa[3]; x += bflo(a0.z) * wa[4]; x += bfhi(a0.z) * wa[5]; x += bflo(a0.w) * wa[6]; x += bfhi(a0.w) * wa[7];
            x += bflo(a1.x) * wa[8]; x += bfhi(a1.x) * wa[9]; x += bflo(a1.y) * wa[10]; x += bfhi(a1.y) * wa[11]; x += bflo(a1.z) * wa[12]; x += bfhi(a1.z) * wa[13]; x += bflo(a1.w) * wa[14]; x += bfhi(a1.w) * wa[15];
            run += logsig16(x); Bt[t] = run;
            q[t] = bf2f(z[(size_t)(rowb + t) * NZ + ZQ + col]); k[t] = bf2f(z[(size_t)(rowb + t) * NZ + ZK + col]); }
#pragma unroll
        for (int t = 0; t < 4; ++t) { EQ[t * 128 + d] = q[t] * __expf(Bt[t]) * QSCALE; KD[t * 128 + d] = k[t] * __expf(Bt[3] - Bt[t]); }
        DD[d] = __expf(Bt[3]);
        float pa[10];
#pragma unroll
        for (int i = 0; i < 4; ++i)
#pragma unroll
            for (int j = 0; j <= i; ++j) pa[i * (i + 1) / 2 + j] = q[i] * k[j] * __expf(Bt[i] - Bt[j]) * QSCALE;
#pragma unroll
        for (int e = 0; e < 10; ++e) {
#pragma unroll
            for (int o = 1; o < 64; o <<= 1) pa[e] += __shfl_xor(pa[e], o);
            if (lane == 0) AMP[wave * 10 + e] = pa[e]; }
    }
    for (int e = tid; e < 1024; e += NTHR) { const int t = e >> 8, vv = e & 255; VV[e] = bf2f(z[(size_t)(rowb + t) * NZ + ZV + h * 256 + vv]); }
    __syncthreads();
    { const int vv0 = 4 * (tid & 63), dg = tid >> 6;
      f32x4 vr[4], oacc[4];
#pragma unroll
      for (int t = 0; t < 4; ++t) { vr[t] = *(const LAS f32x4*)(VV + t * 256 + vv0); oacc[t] = (f32x4){0.f, 0.f, 0.f, 0.f}; }
      const size_t sbase = (((size_t)(l * NSMP + s) * 4 + h) * 128) * 256;
      const float* S0 = A.in[I_SG] + sbase; float* SN = A.out + O_SGS + sbase;
#pragma unroll 4
      for (int dd = 0; dd < 16; ++dd) { const int d = 16 * dg + dd;
          const f32x4 s0 = *(const f32x4*)(S0 + (size_t)d * 256 + vv0);
          const float e0 = EQ[d], e1 = EQ[128 + d], e2 = EQ[256 + d], e3 = EQ[384 + d], k0 = KD[d], k1 = KD[128 + d], k2 = KD[256 + d], k3 = KD[384 + d], Dd = DD[d];
          oacc[0] += s0 * e0; oacc[1] += s0 * e1; oacc[2] += s0 * e2; oacc[3] += s0 * e3;
          const f32x4 sn = s0 * Dd + vr[0] * k0 + vr[1] * k1 + vr[2] * k2 + vr[3] * k3;
          *(f32x4*)(SN + (size_t)d * 256 + vv0) = sn; }
#pragma unroll
      for (int t = 0; t < 4; ++t) *(LAS f32x4*)(OACC + (dg * 4 + t) * 256 + vv0) = oacc[t]; }
    __syncthreads();
    { const int vv = tid & 255, tp = tid >> 8; float oo[2];
#pragma unroll
      for (int tt = 0; tt < 2; ++tt) { const int t = 2 * tp + tt; float o = 0.f;
#pragma unroll
          for (int dg = 0; dg < 8; ++dg) o += OACC[(dg * 4 + t) * 256 + vv];
          for (int j = 0; j <= t; ++j) { const int e = t * (t + 1) / 2 + j; o += (AMP[e] + AMP[10 + e]) * VV[j * 256 + vv]; }
          oo[tt] = o; float sq = o * o;
#pragma unroll
          for (int of = 1; of < 64; of <<= 1) sq += __shfl_xor(sq, of);
          if (lane == 0) RSS[wave * 2 + tt] = sq; }
      __syncthreads();
#pragma unroll
      for (int tt = 0; tt < 2; ++tt) { const int t = 2 * tp + tt; const int w0 = 4 * tp;
          const float tot = RSS[(w0 + 0) * 2 + tt] + RSS[(w0 + 1) * 2 + tt] + RSS[(w0 + 2) * 2 + tt] + RSS[(w0 + 3) * 2 + tt];
          const float rstd = __builtin_amdgcn_rsqf(tot * (1.0f / 256.0f) + EPS);
          const int c = h * 256 + vv; const float ga = bf2f(z[(size_t)(rowb + t) * NZ + ZGA + c]);
          ain[(size_t)(rowb + t) * DM + c] = f2bf(oo[tt] * rstd * A.in[I_GAIN][l * DM + c] * siluf_(ga)); } }
    __syncthreads();
}

__device__ __forceinline__ void p2_pool_item(const Args& A, unsigned char* ws, LAS unsigned char* lds, int l, int idx, int tid, int lane, int wave) {
    const bf16* z = (const bf16*)(ws + WS_Z); bf16* bin = (bf16*)(ws + WS_BIN);
    const bf16* pwt = (const bf16*)(ws + WS_PWT);
    const int g = idx & 3, colb = g * 128, w = 2 << g;
    int kind, r0 = 0, s0 = 0, nout, nslots;
    if (idx < 512) { kind = 0; r0 = (idx >> 2) * 128; nout = 128; nslots = 143; }
    else if (idx < 544) { kind = 1; s0 = ((idx - 512) >> 2) * 16; nout = 64; nslots = 304; }
    else { kind = 2; nout = 16; nslots = 31; }
    constexpr int EXT = 0, ZP = 77824, PWL = 112640, ZS = 272;
    const float* sp = A.in[I_SP];
    for (int ch = tid; ch < nslots * 16; ch += NTHR) { const int slot = ch >> 4, c8 = ch & 15; u32x4 v = (u32x4){0u, 0u, 0u, 0u};
        if (kind == 0) { const int srow = slot < 15 ? (((r0 & 2047) == 0) ? R_META + 1 + slot : r0 - 15 + slot) : r0 + slot - 15;
            v = *(const u32x4*)(z + (size_t)srow * NZ + ZU + colb + c8 * 8); }
        else if (kind == 1) { const int sq = slot / 19, e = slot % 19, s = s0 + sq;
            if (e < 15) { const float* p = sp + ((size_t)(l * NSMP + s) * 15 + e) * 512 + colb + c8 * 8; const f32x4 a = *(const f32x4*)p, b = *(const f32x4*)(p + 4);
                v.x = pk2(a[0], a[1]); v.y = pk2(a[2], a[3]); v.z = pk2(b[0], b[1]); v.w = pk2(b[2], b[3]); }
            else v = *(const u32x4*)(z + (size_t)(R_SMP + s * 4 + e - 15) * NZ + ZU + colb + c8 * 8); }
        else { if (slot >= 15) v = *(const u32x4*)(z + (size_t)(R_META + slot - 15) * NZ + ZU + colb + c8 * 8); }
        *(LAS u32x4*)(lds + EXT + slot * 256 + c8 * 16) = v; }
    for (int ch = tid; ch < 128 * 16; ch += NTHR) { const int dr = ch >> 4, c8 = ch & 15;
        *(LAS u32x4*)(lds + PWL + dr * ZS + c8 * 16) = *(const u32x4*)(pwt + ((size_t)(l * 4 + g) * 128 + dr) * 128 + c8 * 8); }
    __syncthreads();
    { const int pair = tid & 63;
      for (int k = 0; k < 16; ++k) { const int i = (tid >> 6) + 8 * k; float zx = 0.f, zy = 0.f;
          if (i < nout) { const int slot = (kind == 1) ? (i >> 2) * 19 + 15 + (i & 3) : 15 + i; const int cnt = (kind == 2) ? (w < i + 1 ? w : i + 1) : w;
              float sx = 0.f, sy = 0.f;
              for (int j = 0; j < w; ++j) { const unsigned wd = *(const LAS unsigned*)(lds + EXT + (slot - j) * 256 + pair * 4); sx += bflo(wd); sy += bfhi(wd); }
              const unsigned cur = *(const LAS unsigned*)(lds + EXT + slot * 256 + pair * 4); const float ic = 1.0f / (float)cnt;
              zx = sx * ic - bflo(cur); zy = sy * ic - bfhi(cur); }
          *(LAS unsigned*)(lds + ZP + i * ZS + pair * 4) = pk2(zx, zy); } }
    __syncthreads();
    { f32x4 acc[8][1];
#pragma unroll
      for (int m = 0; m < 8; ++m) acc[m][0] = (f32x4){0.f, 0.f, 0.f, 0.f};
      lds_mma<8, 1, 4>(acc, lds + PWL, ZS, lds + ZP + 16 * wave * ZS, ZS, lane);
      const int fr = lane & 15, fq = lane >> 4, i = 16 * wave + fr;
      if (i < nout) { const int zrow = (kind == 0) ? r0 + i : (kind == 1 ? R_SMP + (s0 + (i >> 2)) * 4 + (i & 3) : R_META + i);
#pragma unroll
          for (int m = 0; m < 8; ++m) { const int d0 = 16 * m + 4 * fq;
              const f32x4 sc = *(const f32x4*)(A.in[I_PSC] + l * 512 + colb + d0);
              const u32x2 gb = *(const u32x2*)(z + (size_t)zrow * NZ + ZGB + colb + d0);
              const float y0 = acc[m][0][0] * sc[0] * siluf_(bflo(gb.x)), y1 = acc[m][0][1] * sc[1] * siluf_(bfhi(gb.x));
              const float y2 = acc[m][0][2] * sc[2] * siluf_(bflo(gb.y)), y3 = acc[m][0][3] * sc[3] * siluf_(bfhi(gb.y));
              u32x2 o; o.x = pk2(y0, y1); o.y = pk2(y2, y3);
              *(u32x2*)(bin + (size_t)zrow * 512 + colb + d0) = o; } } }
    if (kind == 0 && ((r0 + 128) & 2047) == 0) { const int b = r0 >> 11; float* o3 = A.out + O_SPP;
        for (int e = tid; e < 15 * 128; e += NTHR) { const int i = e >> 7, c = e & 127;
            o3[((size_t)(l * NBATCH + b) * 15 + i) * 512 + colb + c] = bf2f(*(const LAS bf16*)(lds + EXT + (15 + 113 + i) * 256 + c * 2)); } }
    if (kind == 1) { float* o5 = A.out + O_SPS;
        for (int e = tid; e < 16 * 15 * 128; e += NTHR) { const int sq = e / 1920, rem = e % 1920, ee = rem >> 7, c = rem & 127, s = s0 + sq;
            const float val = (ee + 4 < 15) ? sp[((size_t)(l * NSMP + s) * 15 + ee + 4) * 512 + colb + c] : bf2f(*(const LAS bf16*)(lds + EXT + (sq * 19 + ee + 4) * 256 + c * 2));
            o5[((size_t)(l * NSMP + s) * 15 + ee) * 512 + colb + c] = val; } }
    __syncthreads();
}

__device__ __forceinline__ void p3_item(const Args& A, unsigned char* ws, LAS unsigned char* lds, int l, int item, int tid, int lane, int wave) {
    const bf16* z = (const bf16*)(ws + WS_Z); const bf16* qt = (const bf16*)(ws + WS_QT); const bf16* kt = (const bf16*)(ws + WS_KT); const bf16* vtg = (const bf16*)(ws + WS_VT);
    const bf16* UT = (const bf16*)(ws + WS_UT); const float* Dg = (const float*)(ws + WS_DG); bf16* ain = (bf16*)(ws + WS_AIN);
    const int rt = item >> 2, h = item & 3; const bool meta = (rt == 64);
    const int row0 = meta ? R_META : rt * 256, nrows = meta ? 16 : 256, b = rt >> 3, sc = rt & 7;
    constexpr int ST = 0, QL = 69632, KL = 87040, VL = 104448, PL = 141312, RSL = 150528, S128 = 272, S64 = 144;
    const int fr = lane & 15, fq = lane >> 4;
    if (!meta) {
        const int d0 = (tid & 15) * 8, vb = tid >> 4;
        float S[8][8];
        { const size_t im = (size_t)(256 + h);
#pragma unroll
          for (int i = 0; i < 8; ++i) { const u32x4 u = *(const u32x4*)(UT + (im * 256 + vb + 32 * i) * 128 + d0);
              S[i][0] = bflo(u.x); S[i][1] = bfhi(u.x); S[i][2] = bflo(u.y); S[i][3] = bfhi(u.y); S[i][4] = bflo(u.z); S[i][5] = bfhi(u.z); S[i][6] = bflo(u.w); S[i][7] = bfhi(u.w); } }
#define P3_PARK() do { _Pragma("unroll") for (int i = 0; i < 8; ++i) { u32x4 w; w.x = pk2(S[i][0], S[i][1]); w.y = pk2(S[i][2], S[i][3]); w.z = pk2(S[i][4], S[i][5]); w.w = pk2(S[i][6], S[i][7]); \
            *(LAS u32x4*)(lds + ST + (vb + 32 * i) * S128 + d0 * 2) = w; } } while (0)
        const int nsteps = sc + (sc == 7 ? 1 : 0);
#pragma unroll 1
        for (int scp = 0; scp < nsteps; ++scp) {
            if (scp == sc) P3_PARK();
            const size_t itp = (size_t)((b * 8 + scp) * 4 + h);
            const f32x4 da = *(const f32x4*)(Dg + itp * 128 + d0), db = *(const f32x4*)(Dg + itp * 128 + d0 + 4);
#pragma unroll
            for (int i = 0; i < 8; ++i) { const u32x4 u = *(const u32x4*)(UT + (itp * 256 + vb + 32 * i) * 128 + d0);
                S[i][0] = da[0] * S[i][0] + bflo(u.x); S[i][1] = da[1] * S[i][1] + bfhi(u.x); S[i][2] = da[2] * S[i][2] + bflo(u.y); S[i][3] = da[3] * S[i][3] + bfhi(u.y);
                S[i][4] = db[0] * S[i][4] + bflo(u.z); S[i][5] = db[1] * S[i][5] + bfhi(u.z); S[i][6] = db[2] * S[i][6] + bflo(u.w); S[i][7] = db[3] * S[i][7] + bfhi(u.w); }
        }
        if (sc != 7) P3_PARK();
        else {
            float* o2 = A.out + O_SGP + (((size_t)(l * NBATCH + b) * 4 + h) * 128) * 256;
#pragma unroll
            for (int i = 0; i < 8; ++i)
#pragma unroll
                for (int e = 0; e < 8; ++e) o2[(size_t)(d0 + e) * 256 + vb + 32 * i] = S[i][e];
        }
#undef P3_PARK
    }
    const int nqb = meta ? 1 : 4;
#pragma unroll 1
    for (int qb = 0; qb < nqb; ++qb) {
        __syncthreads();
        for (int ch = tid; ch < 64 * 16; ch += NTHR) { const int row = ch >> 4, c = ch & 15; u32x4 v = (u32x4){0u, 0u, 0u, 0u};
            if (qb * 64 + row < nrows) v = *(const u32x4*)(qt + (size_t)(row0 + qb * 64 + row) * 512 + h * 128 + c * 8);
            *(LAS u32x4*)(lds + QL + row * S128 + c * 16) = v; }
        f32x4 acc[2][4];
#pragma unroll
        for (int m = 0; m < 2; ++m)
#pragma unroll
            for (int n = 0; n < 4; ++n) acc[m][n] = (f32x4){0.f, 0.f, 0.f, 0.f};
#pragma unroll 1
        for (int j = 0; j <= qb; ++j) {
            if (j > 0) __syncthreads();
            for (int ch = tid; ch < 64 * 16; ch += NTHR) { const int row = ch >> 4, c = ch & 15; u32x4 v = (u32x4){0u, 0u, 0u, 0u};
                if (j * 64 + row < nrows) v = *(const u32x4*)(kt + (size_t)(row0 + j * 64 + row) * 512 + h * 128 + c * 8);
                *(LAS u32x4*)(lds + KL + row * S128 + c * 16) = v; }
            for (int ch = tid; ch < 256 * 8; ch += NTHR) { const int vv = ch >> 3, c = ch & 7; u32x4 v = (u32x4){0u, 0u, 0u, 0u};
                if (j * 64 + c * 8 < nrows) v = *(const u32x4*)(vtg + (size_t)(h * 256 + vv) * R + row0 + j * 64 + c * 8);
                *(LAS u32x4*)(lds + VL + vv * S64 + c * 16) = v; }
            __syncthreads();
            { f32x4 pacc[1][2]; pacc[0][0] = (f32x4){0.f, 0.f, 0.f, 0.f}; pacc[0][1] = (f32x4){0.f, 0.f, 0.f, 0.f};
              const int jt = wave & 3, it0 = 2 * (wave >> 2);
              lds_mma<1, 2, 4>(pacc, lds + KL + 16 * jt * S128, S128, lds + QL + 16 * it0 * S128, S128, lane);
#pragma unroll
              for (int n = 0; n < 2; ++n) { const int i = 16 * (it0 + n) + fr, jj = 16 * jt + 4 * fq; f32x4 p = pacc[0][n];
                  if (j == qb) { p[0] = (jj + 0 <= i) ? p[0] : 0.f; p[1] = (jj + 1 <= i) ? p[1] : 0.f; p[2] = (jj + 2 <= i) ? p[2] : 0.f; p[3] = (jj + 3 <= i) ? p[3] : 0.f; }
                  u32x2 w; w.x = pk2(p[0], p[1]); w.y = pk2(p[2], p[3]);
                  *(LAS u32x2*)(lds + PL + i * S64 + jj * 2) = w; } }
            __syncthreads();
            lds_mma<2, 4, 2>(acc, lds + VL + 32 * wave * S64, S64, lds + PL, S64, lane);
        }
        if (!meta) lds_mma<2, 4, 4>(acc, lds + ST + 32 * wave * S128, S128, lds + QL, S128, lane);
#pragma unroll
        for (int n = 0; n < 4; ++n) { float s = 0.f;
#pragma unroll
            for (int m = 0; m < 2; ++m) s += (acc[m][n][0] * acc[m][n][0] + acc[m][n][1] * acc[m][n][1]) + (acc[m][n][2] * acc[m][n][2] + acc[m][n][3] * acc[m][n][3]);
            s += __shfl_xor(s, 16); s += __shfl_xor(s, 32);
            if (fq == 0) ((LAS float*)(lds + RSL))[wave * 64 + 16 * n + fr] = s; }
        __syncthreads();
#pragma unroll
        for (int n = 0; n < 4; ++n) { const int i = 16 * n + fr; float tot = 0.f;
#pragma unroll
            for (int w8 = 0; w8 < 8; ++w8) tot += ((const LAS float*)(lds + RSL))[w8 * 64 + i];
            const float rstd = __builtin_amdgcn_rsqf(tot * (1.0f / 256.0f) + EPS);
            if (qb * 64 + i < nrows) { const size_t grow = (size_t)(row0 + qb * 64 + i);
#pragma unroll
                for (int m = 0; m < 2; ++m) { const int c = h * 256 + 32 * wave + 16 * m + 4 * fq;
                    const f32x4 gn = *(const f32x4*)(A.in[I_GAIN] + l * DM + c);
                    const u32x2 ga = *(const u32x2*)(z + grow * NZ + ZGA + c);
                    const float y0 = acc[m][n][0] * rstd * gn[0] * siluf_(bflo(ga.x)), y1 = acc[m][n][1] * rstd * gn[1] * siluf_(bfhi(ga.x));
                    const float y2 = acc[m][n][2] * rstd * gn[2] * siluf_(bflo(ga.y)), y3 = acc[m][n][3] * rstd * gn[3] * siluf_(bfhi(ga.y));
                    u32x2 o; o.x = pk2(y0, y1); o.y = pk2(y2, y3);
                    *(u32x2*)(ain + grow * DM + c) = o; } } }
    }
    __syncthreads();
}

__device__ __forceinline__ void pf_final(const Args& A, unsigned char* ws, int lane, int wave) {
    const bf16* hb = (const bf16*)(ws + WS_HB); const float* ss = (const float*)(ws + WS_SS) + (size_t)2 * R * 16; const float* fg = A.in[I_FG];
    const int gw = blockIdx.x * NWAVES + wave, NGW = gridDim.x * NWAVES;
    for (int row = gw; row < R_META; row += NGW) {
        const float rs = __builtin_amdgcn_rsqf(ss_sum16(ss + (size_t)row * 16) * (1.0f / 1024.0f) + EPS);
        float* o = A.out + (row < R_SMP ? O_YP + (size_t)row * DM : O_YS + (size_t)(row - R_SMP) * DM);
#pragma unroll
        for (int j = 0; j < 2; ++j) { const int c = 8 * (lane + 64 * j); const u32x4 u = *(const u32x4*)(hb + (size_t)row * DM + c);
            const f32x4 g0 = *(const f32x4*)(fg + c), g1 = *(const f32x4*)(fg + c + 4);
            f32x4 a, bb; a[0] = bflo(u.x) * rs * g0[0]; a[1] = bfhi(u.x) * rs * g0[1]; a[2] = bflo(u.y) * rs * g0[2]; a[3] = bfhi(u.y) * rs * g0[3];
            bb[0] = bflo(u.z) * rs * g1[0]; bb[1] = bfhi(u.z) * rs * g1[1]; bb[2] = bflo(u.w) * rs * g1[2]; bb[3] = bfhi(u.w) * rs * g1[3];
            *(f32x4*)(o + c) = a; *(f32x4*)(o + c + 4) = bb; }
    }
}

#ifndef ABL
#define ABL 0
#endif
__global__ void __launch_bounds__(NTHR, 2) hybrid_fwd(Args A) {
    extern __shared__ __attribute__((aligned(16))) unsigned char lds_raw[];
    LAS unsigned char* lds = (LAS unsigned char*)lds_raw;
    const int tid0 = threadIdx.x;
    const int G = gridDim.x, bid = blockIdx.x;
    unsigned char* ws0 = A.ws;
    volatile LAS unsigned* MISC = (volatile LAS unsigned*)(lds + LDS_CTL_OFF);
    if (tid0 < 64) MISC[tid0] = 0u;
    __syncthreads();
    const int lo = A.ph_lo, hi = A.ph_hi;
    const bool use_bar = (hi - lo) > 1;
    XcdBarrier bar; bar.bar = (unsigned*)(ws0 + WS_CTL) + 4096; bar.x = 0; bar.st = MISC + 8;
    if (use_bar) bar = xcd_barrier_post((unsigned*)(ws0 + WS_CTL) + 4096, MISC + 8);
#define IN(k) (lo <= (k) && (k) < hi)
#define PH_BEGIN() int tid = tid0; asm volatile("" : "+v"(tid)); const int lane = tid & 63; const int wave = __builtin_amdgcn_readfirstlane(tid >> 6); unsigned char* ws = ws0; asm volatile("" : "+s"(ws)); (void)lane; (void)wave; (void)ws
#define SEAM(k) do { if (IN(k) && IN((k) + 1)) xcd_barrier(bar); } while (0)

    if (IN(0) && !(ABL & 1)) { PH_BEGIN(); p0_prologue(A, ws, lds, tid, lane, wave); __syncthreads(); }
    SEAM(0);
#pragma unroll 1
    for (int l = 0; l < DEPTH; ++l) {
        const int pb = 1 + 5 * l;
        if (IN(pb) && !(ABL & 2)) {
            PH_BEGIN(); bf16* hb = (bf16*)(ws + WS_HB); bf16* z = (bf16*)(ws + WS_Z); float* ssb = (float*)(ws + WS_SS);
            pg8::Gemm g{hb, (const bf16*)(ws + WS_WIN) + (size_t)l * NZ * DM, R, NZ, DM}; pg8::StaticOrder S; S.init(R, NZ, G, bid);
            EpiZ E{z, ssb + (size_t)l * R * 16};
            pg8::gemm_phase<EpiZ, pg8::StaticOrder, true, true>(lds, g, S, E, tid);
        }
        SEAM(pb);
        if (IN(pb + 1)) {
            PH_BEGIN();
            for (int it = bid; it < N_GATE_ITEMS + N_POOL_ITEMS + N_SMP_ITEMS; it += G) {
                int tid = tid0; asm volatile("" : "+v"(tid)); const int lane = tid & 63; const int wave = __builtin_amdgcn_readfirstlane(tid >> 6);
                if (it < N_GATE_ITEMS) { if (!(ABL & 4)) p2_gate_item(A, ws, lds, l, it, tid, lane, wave); }
                else if (it < N_GATE_ITEMS + N_POOL_ITEMS) { if (!(ABL & 8)) p2_pool_item(A, ws, lds, l, it - N_GATE_ITEMS, tid, lane, wave); }
                else { if (!(ABL & 16)) p2_sample_item(A, ws, lds, l, it - N_GATE_ITEMS - N_POOL_ITEMS, tid, lane, wave); }
            }
        }
        SEAM(pb + 1);
        if (IN(pb + 2)) {
            PH_BEGIN();
            if (!(ABL & 32)) for (int it = bid; it < N_GATE_ITEMS; it += G) p3_item(A, ws, lds, l, it, tid, lane, wave);
        }
        SEAM(pb + 2);
        if (IN(pb + 3) && !(ABL & 64)) {
            PH_BEGIN(); bf16* z = (bf16*)(ws + WS_Z);
            { pg8::Gemm g{(const bf16*)(ws + WS_AIN), (const bf16*)(ws + WS_WA) + (size_t)l * DM * DM, R, DM, DM}; pg8::StaticOrder S; S.init(R, DM, G, bid);
              EpiGate<false> E{z, A.in[I_BM] + l * 2048, (bf16*)(ws + WS_MRG)};
              pg8::gemm_phase<EpiGate<false>, pg8::StaticOrder, true, true>(lds, g, S, E, tid); }
            asm volatile("s_waitcnt vmcnt(0)" ::: "memory"); __syncthreads();
            { pg8::Gemm g{(const bf16*)(ws + WS_BIN), (const bf16*)(ws + WS_WB) + (size_t)l * DM * 512, R, DM, 512}; pg8::StaticOrder S; S.init(R, DM, G, bid);
              EpiGate<true> E{z, A.in[I_BM] + l * 2048, (bf16*)(ws + WS_MRG)};
              pg8::gemm_phase<EpiGate<true>, pg8::StaticOrder, true, true>(lds, g, S, E, tid); }
        }
        SEAM(pb + 3);
        if (IN(pb + 4) && !(ABL & 128)) {
            PH_BEGIN(); bf16* hb = (bf16*)(ws + WS_HB); float* ssb = (float*)(ws + WS_SS);
            pg8::Gemm g{(const bf16*)(ws + WS_MRG), (const bf16*)(ws + WS_WO) + (size_t)l * DM * DM, R, DM, DM}; pg8::StaticOrder S; S.init(R, DM, G, bid);
            EpiOut E{hb, ssb + (size_t)(l + 1) * R * 16};
            pg8::gemm_phase<EpiOut, pg8::StaticOrder, true, true>(lds, g, S, E, tid);
        }
        SEAM(pb + 4);
    }
    if (IN(11) && !(ABL & 256)) { PH_BEGIN(); pf_final(A, ws, lane, wave); }
#undef IN
#undef SEAM
}


#ifdef PROBE_K
__global__ void __launch_bounds__(256) probe_dump(const unsigned short* wsb, float* out, size_t n16, size_t nout) {
    for (size_t i = (size_t)blockIdx.x * blockDim.x + threadIdx.x; i < nout; i += (size_t)gridDim.x * blockDim.x) {
        float acc = 0.f;
        for (size_t k = i; k < n16; k += nout) { float v = __uint_as_float((unsigned)wsb[k] << 16); if (!(fabsf(v) < 1e30f)) v = 3.0f; acc += v; }
        out[i] = acc;
    }
}
#endif
#ifndef MK_N_LAUNCHES
#define MK_N_LAUNCHES 12
#endif
extern "C" void kernel_launch(void* const* d_in, const int* in_sizes, int n_in, void* d_out, int out_size, void* d_ws, size_t ws_size, hipStream_t stream) {
    static int grid = 0;
    if (grid == 0) {
        if (n_in != 17 || out_size != (int)O_END || ws_size < WS_END) { fprintf(stderr, "kernel_launch: unexpected shapes (n_in %d, out %d, ws %zu)\n", n_in, out_size, ws_size); grid = -1; return; }
        int dev = 0, cus = 0, per_cu = 0;
        if (hipGetDevice(&dev) != hipSuccess || hipDeviceGetAttribute(&cus, hipDeviceAttributeMultiprocessorCount, dev) != hipSuccess) { grid = -1; return; }
        if (hipFuncSetAttribute((const void*)hybrid_fwd, hipFuncAttributeMaxDynamicSharedMemorySize, LDS_BYTES) != hipSuccess) { fprintf(stderr, "kernel_launch: hipFuncSetAttribute failed\n"); grid = -1; return; }
        if (hipOccupancyMaxActiveBlocksPerMultiprocessor(&per_cu, (const void*)hybrid_fwd, NTHR, LDS_BYTES) != hipSuccess || per_cu < 1) { fprintf(stderr, "kernel_launch: occupancy query says %d blocks/CU\n", per_cu); (void)hipGetLastError(); grid = -1; return; }
        grid = cus;
    }
    if (grid < 0) return;
    Args a{};
    for (int i = 0; i < 17; ++i) a.in[i] = (const float*)d_in[i];
    a.out = (float*)d_out; a.ws = (unsigned char*)d_ws;
    if (MK_N_LAUNCHES == 1) {
        (void)hipMemsetAsync((char*)d_ws + WS_CTL, 0, CTL_BYTES, stream);
        a.ph_lo = 0; a.ph_hi = N_PHASES;
        hipLaunchKernelGGL(hybrid_fwd, dim3(grid), dim3(NTHR), LDS_BYTES, stream, a);
    } else {
#ifdef PROBE_K
        for (int p = 0; p < PROBE_K; ++p) { a.ph_lo = p; a.ph_hi = p + 1; hipLaunchKernelGGL(hybrid_fwd, dim3(grid), dim3(NTHR), LDS_BYTES, stream, a); }
        hipLaunchKernelGGL(probe_dump, dim3(2048), dim3(256), 0, stream, (const unsigned short*)((const char*)d_ws + WS_WIN), (float*)d_out, (size_t)(WS_END - WS_WIN) / 2, (size_t)O_END);
#else
        for (int p = 0; p < N_PHASES; ++p) { a.ph_lo = p; a.ph_hi = p + 1; hipLaunchKernelGGL(hybrid_fwd, dim3(grid), dim3(NTHR), LDS_BYTES, stream, a); }
#endif
    }
}
```
